# Optimizing an MI355X kernel written in HIP

```python
import jax, jax.numpy as jnp
from jax import lax
import numpy as np

D_MODEL = 2048
BATCH = 4
SEQ = 2048
DEPTH = 1

CONV_CH = 1024
CONV_K = 31
N_HEADS = 8
QK_NOPE = 128
QK_ROPE = 64
V_HEAD = 128
QK_HEAD = QK_NOPE + QK_ROPE
Q_LORA = 768
KV_LORA = 512
ATTN_CH = N_HEADS * V_HEAD
MIX_WIDTH = CONV_CH + ATTN_CH
IN_COLS = 2 * CONV_CH + Q_LORA + KV_LORA + QK_ROPE
ROPE_THETA = 10000.0
Q_BLOCK = 128
D_FF = ((8 * D_MODEL // 3 + 255) // 256) * 256
EPS = 1e-6

kernel_name = "hymba_conformer_mla_sandwich_layer"


def rmsnorm(x, g):
    xf = x.astype(jnp.float32)
    y = xf * lax.rsqrt(jnp.mean(xf * xf, axis=-1, keepdims=True) + EPS)
    return (y * g.astype(jnp.float32)).astype(x.dtype)


def layernorm(x, g, b):
    xf = x.astype(jnp.float32)
    mu = jnp.mean(xf, axis=-1, keepdims=True)
    var = jnp.mean(jnp.square(xf - mu), axis=-1, keepdims=True)
    y = (xf - mu) * lax.rsqrt(var + EPS)
    return (y * g.astype(jnp.float32) + b.astype(jnp.float32)).astype(x.dtype)


def rope_tables(positions, dtype):
    inv_freq = ROPE_THETA ** (-jnp.arange(0, QK_ROPE, 2, dtype=jnp.float32) / QK_ROPE)
    ang = positions.astype(jnp.float32)[..., None] * inv_freq
    return jnp.cos(ang).astype(dtype), jnp.sin(ang).astype(dtype)


def apply_rope(x, cos, sin):
    x1, x2 = jnp.split(x, 2, axis=-1)
    return jnp.concatenate([x1 * cos - x2 * sin, x2 * cos + x1 * sin], axis=-1)


def causal_depthwise_conv(u, w, b):
    y = lax.conv_general_dilated(
        u, w[:, None, :], window_strides=(1,), padding=[(CONV_K - 1, 0)],
        dimension_numbers=("NWC", "WIO", "NWC"), feature_group_count=u.shape[-1])
    return y + b


def causal_attention(q, k, v):
    B, S, H, Dq = q.shape
    nblk = S // Q_BLOCK
    qb = q.reshape(B, nblk, Q_BLOCK, H, Dq).transpose(1, 0, 2, 3, 4)
    kpos = jnp.arange(S)
    scale = Dq ** -0.5
    neg = jnp.finfo(jnp.float32).min

    def one_block(args):
        i, qi = args
        s = jnp.einsum('bqhd,bkhd->bhqk', qi, k).astype(jnp.float32) * scale
        qpos = i * Q_BLOCK + jnp.arange(Q_BLOCK)
        s = jnp.where(kpos[None, :] <= qpos[:, None], s, neg)
        p = jax.nn.softmax(s, axis=-1).astype(v.dtype)
        return jnp.einsum('bhqk,bkhd->bqhd', p, v)

    out = lax.map(one_block, (jnp.arange(nblk), qb))
    return out.transpose(1, 0, 2, 3, 4).reshape(B, S, H * v.shape[-1])


def setup_inputs(seed: int = 0) -> dict:
    key = jax.random.key(seed)
    ks = jax.random.split(key, 24)
    f = jnp.float32
    L = DEPTH

    def w(k, shape, fan_in):
        return jax.random.normal(k, shape, f) * (fan_in ** -0.5)

    def gain(k, n):
        return jnp.ones((L, n), f) + 0.05 * jax.random.normal(k, (L, n), f)

    x = jax.random.normal(ks[0], (BATCH, SEQ, D_MODEL), f)
    offset = jax.random.randint(ks[1], (BATCH, 1), 0, 1024, dtype=jnp.int32)
    positions = offset + jnp.arange(SEQ, dtype=jnp.int32)[None, :]
    return {
        "x": x,
        "positions": positions,
        "pre_mix_norm": gain(ks[2], D_MODEL),
        "w_in": w(ks[3], (L, D_MODEL, IN_COLS), D_MODEL),
        "q_norm": gain(ks[4], Q_LORA),
        "w_uq": w(ks[5], (L, Q_LORA, N_HEADS * QK_HEAD), Q_LORA),
        "kv_norm": gain(ks[6], KV_LORA),
        "w_ukv": w(ks[7], (L, KV_LORA, N_HEADS * (QK_NOPE + V_HEAD)), KV_LORA),
        "conv_w": w(ks[8], (L, CONV_K, CONV_CH), CONV_K),
        "conv_b": 0.02 * jax.random.normal(ks[9], (L, CONV_CH), f),
        "conv_ln_g": gain(ks[10], CONV_CH),
        "conv_ln_b": 0.02 * jax.random.normal(ks[11], (L, CONV_CH), f),
        "conv_out_norm": gain(ks[12], CONV_CH),
        "attn_out_norm": gain(ks[13], ATTN_CH),
        "w_out": w(ks[14], (L, MIX_WIDTH, D_MODEL), MIX_WIDTH),
        "post_mix_norm": gain(ks[15], D_MODEL),
        "pre_ffn_norm": gain(ks[16], D_MODEL),
        "w_gate": w(ks[17], (L, D_MODEL, D_FF), D_MODEL),
        "w_up": w(ks[18], (L, D_MODEL, D_FF), D_MODEL),
        "w_down": w(ks[19], (L, D_FF, D_MODEL), D_FF),
        "post_ffn_norm": gain(ks[20], D_MODEL),
    }


def reference(x, positions, pre_mix_norm, w_in, q_norm, w_uq, kv_norm, w_ukv,
              conv_w, conv_b, conv_ln_g, conv_ln_b, conv_out_norm, attn_out_norm,
              w_out, post_mix_norm, pre_ffn_norm, w_gate, w_up, w_down, post_ffn_norm):
    B, S, _ = x.shape
    cos, sin = rope_tables(positions, x.dtype)
    c1 = 2 * CONV_CH
    c2 = c1 + Q_LORA
    c3 = c2 + KV_LORA
    for l in range(DEPTH):
        h = rmsnorm(x, pre_mix_norm[l])
        z = h @ w_in[l]
        conv_in, q_lat, kv_lat, k_rope = z[..., :c1], z[..., c1:c2], z[..., c2:c3], z[..., c3:]

        a, g = jnp.split(conv_in, 2, axis=-1)
        u = a * jax.nn.sigmoid(g)
        u = causal_depthwise_conv(u, conv_w[l], conv_b[l])
        u = jax.nn.silu(layernorm(u, conv_ln_g[l], conv_ln_b[l]))

        q = (rmsnorm(q_lat, q_norm[l]) @ w_uq[l]).reshape(B, S, N_HEADS, QK_HEAD)
        q_nope, q_pe = q[..., :QK_NOPE], q[..., QK_NOPE:]
        q_pe = apply_rope(q_pe, cos[:, :, None, :], sin[:, :, None, :])
        kv = (rmsnorm(kv_lat, kv_norm[l]) @ w_ukv[l]).reshape(B, S, N_HEADS, QK_NOPE + V_HEAD)
        k_nope, v = kv[..., :QK_NOPE], kv[..., QK_NOPE:]
        k_pe = apply_rope(k_rope, cos, sin)
        k_pe = jnp.broadcast_to(k_pe[:, :, None, :], (B, S, N_HEADS, QK_ROPE))
        q_full = jnp.concatenate([q_nope, q_pe], axis=-1)
        k_full = jnp.concatenate([k_nope, k_pe], axis=-1)
        attn = causal_attention(q_full, k_full, v)

        mix = jnp.concatenate([rmsnorm(u, conv_out_norm[l]),
                               rmsnorm(attn, attn_out_norm[l])], axis=-1) @ w_out[l]
        x = x + rmsnorm(mix, post_mix_norm[l])

        hf = rmsnorm(x, pre_ffn_norm[l])
        ff = (jax.nn.silu(hf @ w_gate[l]) * (hf @ w_up[l])) @ w_down[l]
        x = x + rmsnorm(ff, post_ffn_norm[l])
    return x
```

```cpp
#include <hip/hip_runtime.h>
#include <cstdio>
#include <cstdint>
namespace pg8 {
#define PG8_LAS __attribute__((address_space(3)))
typedef unsigned short bf16_t;
typedef short bf16x8 __attribute__((ext_vector_type(8)));
typedef float f32x4 __attribute__((ext_vector_type(4)));
typedef unsigned u32x4 __attribute__((ext_vector_type(4)));
constexpr int BM = 256, BK = 64, HALF = 128, HTB = HALF * BK * 2  , STAGE_BYTES = 8 * HTB, NXCD = 8, WGM = 8;

__host__ __device__ __forceinline__ int lds_byte(int r, int c) { const int st = (r >> 4) * 2 + (c >> 5), rr = r & 15, cc = c & 31, ob = rr * 64 + cc * 2; return st * 1024 + (ob ^ (((ob >> 9) & 1) << 5)); }
__host__ __device__ __forceinline__ void stage_rc(int b, int& R, int& C) { const int st = b / 1024, sb = b % 1024, swz = sb ^ (((sb >> 9) & 1) << 5); R = (st >> 1) * 16 + swz / 64; C = (st & 1) * 32 + (swz % 64) / 2; }
__host__ __device__ __forceinline__ int perm32(int rho) { const int n = rho >> 4, i = rho & 15; return 8 * (i >> 2) + 4 * n + (i & 3); }

struct Unit { int pm, pn; };
struct Gemm { const bf16_t* A; const bf16_t* Bt; int M, N, K; };

struct StaticOrder {
    int nM, nN, nwg, G, c;
    __host__ __device__ void init(int M, int N, int G_, int c_) { nM = M / BM; nN = N / BM; nwg = nM * nN; G = G_; c = c_; }
    __host__ __device__ bool next(int i, Unit& u) const {
        const long L = (long)i * G + c; if (L >= nwg) return false;
        int wgid = (int)L; { const int q = nwg / NXCD, r = nwg % NXCD, xcd = wgid % NXCD, off = wgid / NXCD; wgid = (xcd < r ? xcd * (q + 1) : r * (q + 1) + (xcd - r) * q) + off; }
        const int nig = WGM * nN, gid = wgid / nig, fm = gid * WGM, gsz = (nM - fm) < WGM ? (nM - fm) : WGM;
        u.pm = fm + ((wgid % nig) % gsz); u.pn = (wgid % nig) / gsz; return true;
    }
    __device__ __forceinline__ void a_ready(const Unit&) const {}
    __device__ __forceinline__ void done(const Unit&) const {}
};

__device__ __forceinline__ unsigned cvt_pk_bf16(float lo, float hi) { unsigned r; asm volatile("v_cvt_pk_bf16_f32 %0, %1, %2" : "=v"(r) : "v"(lo), "v"(hi)); return r; }
__device__ __forceinline__ u32x4 pack8(const f32x4 a, const f32x4 b) { u32x4 w; w.x = cvt_pk_bf16(a[0], a[1]); w.y = cvt_pk_bf16(a[2], a[3]); w.z = cvt_pk_bf16(b[0], b[1]); w.w = cvt_pk_bf16(b[2], b[3]); return w; }
__device__ __forceinline__ float sigm(float g) { return __builtin_amdgcn_rcpf(1.0f + __builtin_amdgcn_exp2f(g * -1.4426950408889634f)); }
__device__ __forceinline__ f32x4 sigm4(const f32x4 g) { return (f32x4){sigm(g[0]), sigm(g[1]), sigm(g[2]), sigm(g[3])}; }
__device__ __forceinline__ float dot4(const f32x4 v) { return (v[0] * v[0] + v[1] * v[1]) + (v[2] * v[2] + v[3] * v[3]); }
constexpr float RMS_EPS = 1e-6f;
constexpr float QSCALE = 0.07216878364870322f * 1.4426950408889634f;

struct EpiZ {
    static constexpr bool PERM = true, AFTER_DRAIN = false;
    bf16_t* U0; bf16_t* QL; bf16_t* KVL; bf16_t* KF; float* ssq_q; float* ssq_kv; const float* cs;
    __device__ __forceinline__ void operator()(const f32x4 (&acc)[2][2][4][2], const Unit& u, int wr, int wc, int fr, int fq) const {
        const int rbase = u.pm * BM + wr * 64 + fr;
        if (u.pn < 8) {
#pragma unroll
            for (int ai = 0; ai < 2; ++ai)
#pragma unroll
                for (int m = 0; m < 4; ++m) { const int row = rbase + ai * HALF + m * 16;
                    const f32x4 v0 = acc[ai][0][m][0] * sigm4(acc[ai][1][m][0]), v1 = acc[ai][0][m][1] * sigm4(acc[ai][1][m][1]);
                    *(u32x4*)(U0 + (size_t)row * 1024 + u.pn * 128 + wc * 32 + 8 * fq) = pack8(v0, v1); }
        } else if (u.pn < 13) {
            const bool isq = u.pn < 11; bf16_t* dst = isq ? QL : KVL; const int ld = isq ? 768 : 512, colt = (u.pn - (isq ? 8 : 11)) * 256; float* ssq = isq ? ssq_q : ssq_kv;
#pragma unroll
            for (int ai = 0; ai < 2; ++ai)
#pragma unroll
                for (int m = 0; m < 4; ++m) { const int row = rbase + ai * HALF + m * 16; float s = 0.f;
#pragma unroll
                    for (int bj = 0; bj < 2; ++bj) { const f32x4 v0 = acc[ai][bj][m][0], v1 = acc[ai][bj][m][1]; s += dot4(v0) + dot4(v1);
                        *(u32x4*)(dst + (size_t)row * ld + colt + bj * HALF + wc * 32 + 8 * fq) = pack8(v0, v1); }
                    s += __shfl_xor(s, 16); s += __shfl_xor(s, 32);
                    if (fq == 0) atomicAdd(ssq + row, s); }
        } else {
            if (wc == 0) {
#pragma unroll
                for (int ai = 0; ai < 2; ++ai)
#pragma unroll
                    for (int m = 0; m < 4; ++m) { const int row = rbase + ai * HALF + m * 16; const int b = row >> 11, t = row & 2047;
                        const f32x4 c0 = *(const f32x4*)(cs + (size_t)row * 64 + 8 * fq), c1 = *(const f32x4*)(cs + (size_t)row * 64 + 8 * fq + 4);
                        const f32x4 s0 = *(const f32x4*)(cs + (size_t)row * 64 + 32 + 8 * fq), s1 = *(const f32x4*)(cs + (size_t)row * 64 + 32 + 8 * fq + 4);
                        const f32x4 x10 = acc[ai][0][m][0], x11 = acc[ai][0][m][1], x20 = acc[ai][1][m][0], x21 = acc[ai][1][m][1];
                        const u32x4 o1 = pack8(x10 * c0 - x20 * s0, x11 * c1 - x21 * s1), o2 = pack8(x20 * c0 + x10 * s0, x21 * c1 + x11 * s1);
#pragma unroll
                        for (int h = 0; h < 8; ++h) { bf16_t* kp = KF + ((size_t)(b * 8 + h) * 2048 + t) * 192 + 128 + 8 * fq; *(u32x4*)kp = o1; *(u32x4*)(kp + 32) = o2; } }
            }
        }
    }
};
struct EpiQ {
    static constexpr bool PERM = true, AFTER_DRAIN = false;
    bf16_t* QF; const float* ssq_q; const float* cs;
    __device__ __forceinline__ void operator()(const f32x4 (&acc)[2][2][4][2], const Unit& u, int wr, int wc, int fr, int fq) const {
        const int rbase = u.pm * BM + wr * 64 + fr;
#pragma unroll
        for (int ai = 0; ai < 2; ++ai)
#pragma unroll
            for (int m = 0; m < 4; ++m) { const int row = rbase + ai * HALF + m * 16; const int b = row >> 11, t = row & 2047;
                const float sc = rsqrtf(ssq_q[row] * (1.0f / 768.0f) + RMS_EPS) * QSCALE;
                if (u.pn < 4) {
#pragma unroll
                    for (int bj = 0; bj < 2; ++bj) { const int h = 2 * u.pn + bj;
                        *(u32x4*)(QF + ((size_t)(b * 8 + h) * 2048 + t) * 192 + wc * 32 + 8 * fq) = pack8(acc[ai][bj][m][0] * sc, acc[ai][bj][m][1] * sc); }
                } else { const int h = 4 * (u.pn - 4) + wc;
                    const f32x4 c0 = *(const f32x4*)(cs + (size_t)row * 64 + 8 * fq) * sc, c1 = *(const f32x4*)(cs + (size_t)row * 64 + 8 * fq + 4) * sc;
                    const f32x4 s0 = *(const f32x4*)(cs + (size_t)row * 64 + 32 + 8 * fq) * sc, s1 = *(const f32x4*)(cs + (size_t)row * 64 + 32 + 8 * fq + 4) * sc;
                    const f32x4 x10 = acc[ai][0][m][0], x11 = acc[ai][0][m][1], x20 = acc[ai][1][m][0], x21 = acc[ai][1][m][1];
                    bf16_t* qp = QF + ((size_t)(b * 8 + h) * 2048 + t) * 192 + 128 + 8 * fq;
                    *(u32x4*)qp = pack8(x10 * c0 - x20 * s0, x11 * c1 - x21 * s1); *(u32x4*)(qp + 32) = pack8(x20 * c0 + x10 * s0, x21 * c1 + x11 * s1); }
            }
    }
};
struct EpiKV {
    static constexpr bool PERM = true, AFTER_DRAIN = false;
    bf16_t* KF; bf16_t* V; const float* ssq_kv;
    __device__ __forceinline__ void operator()(const f32x4 (&acc)[2][2][4][2], const Unit& u, int wr, int wc, int fr, int fq) const {
        const int rbase = u.pm * BM + wr * 64 + fr;
#pragma unroll
        for (int ai = 0; ai < 2; ++ai)
#pragma unroll
            for (int m = 0; m < 4; ++m) { const int row = rbase + ai * HALF + m * 16; const int b = row >> 11, t = row & 2047;
                const float sc = rsqrtf(ssq_kv[row] * (1.0f / 512.0f) + RMS_EPS); const size_t tok = (size_t)(b * 8 + u.pn) * 2048 + t;
                *(u32x4*)(KF + tok * 192 + wc * 32 + 8 * fq) = pack8(acc[ai][0][m][0] * sc, acc[ai][0][m][1] * sc);
                *(u32x4*)(V + tok * 128 + wc * 32 + 8 * fq) = pack8(acc[ai][1][m][0] * sc, acc[ai][1][m][1] * sc); }
    }
};
struct EpiF32SS {
    static constexpr bool PERM = false, AFTER_DRAIN = false;
    float* C; int ldc; float* ssq;
    __device__ __forceinline__ void operator()(const f32x4 (&acc)[2][2][4][2], const Unit& u, int wr, int wc, int fr, int fq) const {
        const int rbase = u.pm * BM + wr * 64 + fr, col0 = u.pn * BM + wc * 32 + 4 * fq;
#pragma unroll
        for (int ai = 0; ai < 2; ++ai)
#pragma unroll
            for (int m = 0; m < 4; ++m) { const int row = rbase + ai * HALF + m * 16; float* rowp = C + (size_t)row * ldc + col0; float s = 0.f;
#pragma unroll
                for (int bj = 0; bj < 2; ++bj)
#pragma unroll
                    for (int n = 0; n < 2; ++n) { const f32x4 v = acc[ai][bj][m][n]; s += dot4(v); *(f32x4*)(rowp + bj * HALF + n * 16) = v; }
                s += __shfl_xor(s, 16); s += __shfl_xor(s, 32);
                if (fq == 0) atomicAdd(ssq + row, s); }
    }
};
struct EpiSwiGLU {
    static constexpr bool PERM = true, AFTER_DRAIN = false;
    bf16_t* ACT;
    __device__ __forceinline__ void operator()(const f32x4 (&acc)[2][2][4][2], const Unit& u, int wr, int wc, int fr, int fq) const {
        const int rbase = u.pm * BM + wr * 64 + fr;
#pragma unroll
        for (int ai = 0; ai < 2; ++ai)
#pragma unroll
            for (int m = 0; m < 4; ++m) { const int row = rbase + ai * HALF + m * 16;
                const f32x4 g0 = acc[ai][0][m][0], g1 = acc[ai][0][m][1];
                *(u32x4*)(ACT + (size_t)row * 5632 + u.pn * 128 + wc * 32 + 8 * fq) = pack8(g0 * sigm4(g0) * acc[ai][1][m][0], g1 * sigm4(g1) * acc[ai][1][m][1]); }
    }
};

template <class Epi, class Sched, bool ALIGN_EPI = false, bool SP2 = false>
__device__ __forceinline__ void gemm_phase(PG8_LAS unsigned char* lds, const Gemm g, const Sched& S, const Epi& E) {
    const int tid = threadIdx.x, wid = __builtin_amdgcn_readfirstlane(tid >> 6), lane = tid & 63, wr = wid >> 2, wc = wid & 3, fr = lane & 15, fq = lane >> 4;
    const int K = g.K, nt = K / BK;
    unsigned voffA[2], voffB[2];
#pragma unroll
    for (int i = 0; i < 2; ++i) { int R, C; stage_rc(tid * 16 + i * 8192, R, C); const int Rb = Epi::PERM ? ((R & ~31) + perm32(R & 31)) : R;
        voffA[i] = (unsigned)(R * K + C) * 2u; voffB[i] = (unsigned)(Rb * K + C) * 2u; }
    const size_t kstep = (size_t)(BK * 2);
    const size_t hstep = (size_t)HALF * K * 2;
    const size_t tstep = 2 * hstep;
    const unsigned ldsw = (unsigned)wid * 1024u;
    const int aoff = lds_byte(wr * 64 + fr, fq * 8), boff = lds_byte(wc * 32 + fr, fq * 8);
#define PG8_SA(b, h) (((b) * 2 + (h)) * HTB)
#define PG8_SB(b, h) ((4 + (b) * 2 + (h)) * HTB)
#define PG8_STAGE(bufoff, gbase, voff) do { _Pragma("unroll") for (int _i = 0; _i < 2; ++_i) \
        __builtin_amdgcn_global_load_lds((const unsigned*)((const char*)(gbase) + (voff)[_i]), (PG8_LAS unsigned*)(lds + (bufoff) + ldsw + _i * 8192), 16, 0, 0); } while (0)
#define PG8_LDA(dst, b, h) do { _Pragma("unroll") for (int m = 0; m < 4; ++m) _Pragma("unroll") for (int k = 0; k < 2; ++k) dst[m][k] = *(const PG8_LAS bf16x8*)(lds + PG8_SA(b, h) + aoff + m * 2048 + k * 1024); } while (0)
#define PG8_LDB(dst, b, h) do { _Pragma("unroll") for (int n = 0; n < 2; ++n) _Pragma("unroll") for (int k = 0; k < 2; ++k) dst[n][k] = *(const PG8_LAS bf16x8*)(lds + PG8_SB(b, h) + boff + n * 2048 + k * 1024); } while (0)
#define PG8_MMA(ai, bj, At, Bt) do { __builtin_amdgcn_s_setprio(1); _Pragma("unroll") for (int m = 0; m < 4; ++m) _Pragma("unroll") for (int n = 0; n < 2; ++n) _Pragma("unroll") for (int k = 0; k < 2; ++k) \
        acc[ai][bj][m][n] = __builtin_amdgcn_mfma_f32_16x16x32_bf16(Bt[n][k], At[m][k], acc[ai][bj][m][n], 0, 0, 0); __builtin_amdgcn_s_setprio(0); } while (0)
#define PG8_WAIT_V(n) asm volatile("s_waitcnt vmcnt(" #n ")" ::: "memory")
#define PG8_WAIT_L(n) asm volatile("s_waitcnt lgkmcnt(" #n ")" ::: "memory")
#define PG8_BAR __builtin_amdgcn_s_barrier()
#define PG8_SCHED __builtin_amdgcn_sched_barrier(0)
    Unit cur, nxt; int ui = 0;
    if (!S.next(0, cur)) return;
    f32x4 acc[2][2][4][2];
#pragma unroll
    for (int a = 0; a < 2; ++a)
#pragma unroll
        for (int b = 0; b < 2; ++b)
#pragma unroll
            for (int m = 0; m < 4; ++m)
#pragma unroll
                for (int n = 0; n < 2; ++n) acc[a][b][m][n] = (f32x4){0.f, 0.f, 0.f, 0.f};
    bf16x8 At[4][2], B0[2][2], B1[2][2];
    const char* cA = (const char*)g.A + (size_t)cur.pm * tstep; const char* cB = (const char*)g.Bt + (size_t)cur.pn * tstep;
    S.a_ready(cur);
    if constexpr (SP2) {
        PG8_STAGE(PG8_SB(0, 0), cB, voffB); PG8_STAGE(PG8_SB(0, 1), cB + hstep, voffB); PG8_STAGE(PG8_SA(0, 0), cA, voffA); PG8_STAGE(PG8_SA(0, 1), cA + hstep, voffA);
        if (wr == 1) PG8_BAR;
        PG8_WAIT_V(2); PG8_BAR;
        PG8_STAGE(PG8_SB(1, 0), cB + kstep, voffB); PG8_STAGE(PG8_SA(1, 0), cA + kstep, voffA); PG8_STAGE(PG8_SB(1, 1), cB + hstep + kstep, voffB);
        PG8_WAIT_V(6); PG8_BAR;
    } else {
        PG8_STAGE(PG8_SB(0, 0), cB, voffB); PG8_STAGE(PG8_SA(0, 0), cA, voffA); PG8_STAGE(PG8_SB(0, 1), cB + hstep, voffB); PG8_STAGE(PG8_SA(0, 1), cA + hstep, voffA);
        if (wr == 1) PG8_BAR;
        PG8_WAIT_V(4); PG8_BAR;
        PG8_STAGE(PG8_SB(1, 0), cB + kstep, voffB); PG8_STAGE(PG8_SA(1, 0), cA + kstep, voffA); PG8_STAGE(PG8_SB(1, 1), cB + hstep + kstep, voffB);
        PG8_WAIT_V(6); PG8_BAR;
    }
    for (;;) {
        const bool has_next = S.next(ui + 1, nxt);
        const char* nA = has_next ? (const char*)g.A + (size_t)nxt.pm * tstep : cA; const char* nB = has_next ? (const char*)g.Bt + (size_t)nxt.pn * tstep : cB;
        for (int t = 0; t < nt; t += 2) {
            const bool last = (t == nt - 2);
            const char* a1 = cA + (size_t)(t + 1) * kstep;
            const char* a2 = last ? nA : cA + (size_t)(t + 2) * kstep; const char* b2 = last ? nB : cB + (size_t)(t + 2) * kstep;
            const char* a3 = a2 + kstep; const char* b3 = b2 + kstep;
            if (last && has_next) S.a_ready(nxt);
            if constexpr (SP2) {
            PG8_LDB(B0, 0, 0); PG8_LDB(B1, 0, 1); PG8_SCHED; PG8_LDA(At, 0, 0); PG8_STAGE(PG8_SA(1, 1), a1 + hstep, voffA);
            PG8_WAIT_V(8); PG8_WAIT_L(0); PG8_BAR; PG8_MMA(0, 0, At, B0); PG8_MMA(0, 1, At, B1); PG8_BAR; PG8_SCHED;
            PG8_LDA(At, 0, 1); PG8_STAGE(PG8_SB(0, 0), b2, voffB); PG8_STAGE(PG8_SB(0, 1), b2 + hstep, voffB); PG8_STAGE(PG8_SA(0, 0), a2, voffA);
            PG8_WAIT_V(8); PG8_WAIT_L(0); PG8_BAR; PG8_MMA(1, 0, At, B0); PG8_MMA(1, 1, At, B1); PG8_BAR; PG8_SCHED;
            PG8_LDB(B0, 1, 0); PG8_LDB(B1, 1, 1); PG8_SCHED; PG8_LDA(At, 1, 0); PG8_STAGE(PG8_SA(0, 1), a2 + hstep, voffA);
            PG8_WAIT_V(8); PG8_WAIT_L(0); PG8_BAR; PG8_MMA(0, 0, At, B0); PG8_MMA(0, 1, At, B1); PG8_BAR; PG8_SCHED;
            PG8_LDA(At, 1, 1); PG8_STAGE(PG8_SB(1, 0), b3, voffB); PG8_STAGE(PG8_SB(1, 1), b3 + hstep, voffB); PG8_STAGE(PG8_SA(1, 0), a3, voffA);
            PG8_WAIT_V(8); PG8_WAIT_L(0); PG8_BAR; PG8_MMA(1, 0, At, B0); PG8_MMA(1, 1, At, B1); PG8_BAR; PG8_SCHED;
            } else {
            PG8_LDB(B0, 0, 0); PG8_SCHED; PG8_LDA(At, 0, 0); PG8_STAGE(PG8_SA(1, 1), a1 + hstep, voffA);
            PG8_WAIT_L(8); PG8_BAR; PG8_WAIT_L(0); PG8_MMA(0, 0, At, B0); PG8_BAR; PG8_SCHED;
            PG8_LDB(B1, 0, 1); PG8_STAGE(PG8_SB(0, 0), b2, voffB);
            PG8_BAR; PG8_WAIT_L(0); PG8_MMA(0, 1, At, B1); PG8_BAR;
            PG8_LDA(At, 0, 1); PG8_STAGE(PG8_SA(0, 0), a2, voffA);
            PG8_BAR; PG8_WAIT_L(0); PG8_MMA(1, 0, At, B0); PG8_BAR; PG8_SCHED;
            PG8_STAGE(PG8_SB(0, 1), b2 + hstep, voffB);
            PG8_WAIT_V(6); PG8_BAR; PG8_MMA(1, 1, At, B1); PG8_BAR;
            PG8_LDB(B0, 1, 0); PG8_SCHED; PG8_LDA(At, 1, 0); PG8_STAGE(PG8_SA(0, 1), a2 + hstep, voffA);
            PG8_WAIT_L(8); PG8_BAR; PG8_WAIT_L(0); PG8_MMA(0, 0, At, B0); PG8_BAR; PG8_SCHED;
            PG8_LDB(B1, 1, 1); PG8_STAGE(PG8_SB(1, 0), b3, voffB);
            PG8_BAR; PG8_WAIT_L(0); PG8_MMA(0, 1, At, B1); PG8_BAR;
            PG8_LDA(At, 1, 1); PG8_STAGE(PG8_SA(1, 0), a3, voffA);
            PG8_BAR; PG8_WAIT_L(0); PG8_MMA(1, 0, At, B0); PG8_BAR; PG8_SCHED;
            PG8_STAGE(PG8_SB(1, 1), b3 + hstep, voffB);
            PG8_WAIT_V(6); PG8_BAR; PG8_MMA(1, 1, At, B1); PG8_BAR;
            }
        }
        if constexpr (ALIGN_EPI) { if (wr == 0) PG8_BAR; }
        if constexpr (!Epi::AFTER_DRAIN) { E(acc, cur, wr, wc, fr, fq); S.done(cur); }
        if (!has_next) break;
#pragma unroll
        for (int a = 0; a < 2; ++a)
#pragma unroll
            for (int b = 0; b < 2; ++b)
#pragma unroll
                for (int m = 0; m < 4; ++m)
#pragma unroll
                    for (int n = 0; n < 2; ++n) acc[a][b][m][n] = (f32x4){0.f, 0.f, 0.f, 0.f};
        cur = nxt; cA = nA; cB = nB; ++ui;
        if constexpr (ALIGN_EPI) { if (wr == 1) PG8_BAR; }
    }
    PG8_WAIT_V(0);
    if constexpr (!ALIGN_EPI) { if (wr == 0) PG8_BAR; }
    PG8_BAR;
    if constexpr (Epi::AFTER_DRAIN) { E.fused(acc, cur, wr, wc, fr, fq, lds, wid, lane); S.done(cur); }
#undef PG8_SA
#undef PG8_SB
#undef PG8_STAGE
#undef PG8_LDA
#undef PG8_LDB
#undef PG8_MMA
#undef PG8_WAIT_V
#undef PG8_WAIT_L
#undef PG8_BAR
#undef PG8_SCHED
}
}

namespace att {
#define ATT_LAS __attribute__((address_space(3)))
typedef unsigned short bf16_t;
typedef short bf16x8 __attribute__((ext_vector_type(8)));
typedef short s16x4 __attribute__((ext_vector_type(4)));
typedef float f32x16 __attribute__((ext_vector_type(16)));
typedef float f32x4 __attribute__((ext_vector_type(4)));
typedef unsigned u32x4 __attribute__((ext_vector_type(4)));
constexpr int S = 2048, DQK = 192, DV = 128, NH = 8;
constexpr int LDS_K = 0, LDS_V = 128 * 384, LDS_WS = LDS_V + 2 * 16384, LDS_XS = LDS_WS + 8 * 64 * 4, LDS_END = LDS_XS + 4 * 64 * 4;
constexpr float THR = 8.0f;
#define ATT_SBAR() __builtin_amdgcn_sched_barrier(0)
__device__ __forceinline__ int v_st(int k, int c) { const int kk = (k & ~0xC) | ((k & 4) << 1) | ((k & 8) >> 1); return ((kk >> 3) * 4 + (c >> 5)) * 512 + ((kk & 7) * 32 + (c & 31)) * 2; }
__device__ __forceinline__ int v_rd_base(int lane) { return ((lane & 3) << 3) | (((lane >> 2) & 3) << 6) | (((lane >> 4) & 1) << 5) | (((lane >> 5) & 1) << 8); }
__device__ __forceinline__ int crow(int r, int hi) { return (r & 3) + 8 * (r >> 2) + 4 * hi; }
__device__ __forceinline__ unsigned cvtpk(float lo, float hi) { unsigned r; asm volatile("v_cvt_pk_bf16_f32 %0, %1, %2" : "=v"(r) : "v"(lo), "v"(hi)); return r; }

__device__ __forceinline__ void attn_unit(int b, int h, int qb, const bf16_t* QF, const bf16_t* KF, const bf16_t* V, bf16_t* MIX, float* ssq_a, ATT_LAS unsigned char* lds) {
    int tid_ = threadIdx.x; asm volatile("" : "+v"(tid_));
    const int tid = tid_, lane = tid & 63, r32 = lane & 31, hi = lane >> 5; const int wid = __builtin_amdgcn_readfirstlane(tid >> 6);
    const int rg = wid & 3, kh = wid >> 2;
    const size_t bh = (size_t)(b * NH + h);
    const bf16_t* Kg = KF + bh * S * DQK; const bf16_t* Vg = V + bh * S * DV;
    bf16x8 qr[12];
    { const bf16_t* Qw = QF + (bh * S + (size_t)qb * 128 + rg * 32 + r32) * DQK + hi * 8;
#pragma unroll
      for (int d0 = 0; d0 < 12; ++d0) qr[d0] = *(const bf16x8*)(Qw + d0 * 16); }
    const int krow = tid >> 3, kc8 = tid & 7;
    const bf16_t* ksrc = Kg + (size_t)krow * DQK + kc8 * 8;
    const int kdst = LDS_K + krow * 384 + ((kc8 ^ ((krow >> 1) & 7)) << 4);
    const int vkey = tid >> 4, vc = (tid & 15) * 8;
    const bf16_t* vsrc = Vg + (size_t)vkey * DV + vc;
    const int vdst0 = LDS_V + v_st(vkey, vc), vdst1 = LDS_V + v_st(32 + vkey, vc);
    bf16x8 sk[6], sv[4];
#define ATT_LOAD(j) do { const bf16_t* kp_ = ksrc + (size_t)(j) * 128 * DQK; const bf16_t* vp_ = vsrc + (size_t)(j) * 128 * DV; \
        _Pragma("unroll") for (int g = 0; g < 3; ++g) { sk[2 * g] = *(const bf16x8*)(kp_ + g * 64); sk[2 * g + 1] = *(const bf16x8*)(kp_ + 64 * DQK + g * 64); } \
        _Pragma("unroll") for (int i = 0; i < 4; ++i) sv[i] = *(const bf16x8*)(vp_ + (size_t)i * 32 * DV); } while (0)
#define ATT_WRITE() do { _Pragma("unroll") for (int g = 0; g < 3; ++g) { *(ATT_LAS bf16x8*)(lds + kdst + g * 128) = sk[2 * g]; *(ATT_LAS bf16x8*)(lds + kdst + 64 * 384 + g * 128) = sk[2 * g + 1]; } \
        *(ATT_LAS bf16x8*)(lds + vdst0) = sv[0]; *(ATT_LAS bf16x8*)(lds + vdst1) = sv[1]; *(ATT_LAS bf16x8*)(lds + 16384 + vdst0) = sv[2]; *(ATT_LAS bf16x8*)(lds + 16384 + vdst1) = sv[3]; } while (0)
    const int krd = 64 * kh + r32;
    int kb[4];
#pragma unroll
    for (int dd = 0; dd < 4; ++dd) kb[dd] = LDS_K + krd * 384 + (((2 * dd + hi) ^ ((krd >> 1) & 7)) << 4);
    const int vb0 = (int)(uintptr_t)(lds) + LDS_V + kh * 16384 + v_rd_base(lane);
    ATT_LAS float* wsf = (ATT_LAS float*)(lds + LDS_WS) + wid * 64;
    float m_reg = -1e30f, l_reg = 0.f; f32x16 o[4];
#pragma unroll
    for (int d = 0; d < 4; ++d) o[d] = f32x16{};
    const int qpos = qb * 128 + rg * 32 + r32;
    const int nst = qb + 1;
    ATT_LOAD(0);
    for (int j = 0; j < nst; ++j) {
        __syncthreads();
        ATT_WRITE();
        __syncthreads();
        const bool diag = (j == qb);
        if (diag && kh == 1 && rg < 2) continue;
        f32x16 p0 = f32x16{}, p1 = f32x16{};
#pragma unroll
        for (int d0 = 0; d0 < 12; ++d0) { const int a = kb[d0 & 3] + (d0 >> 2) * 128;
            const bf16x8 k0 = *(const ATT_LAS bf16x8*)(lds + a), k1 = *(const ATT_LAS bf16x8*)(lds + a + 32 * 384);
            p0 = __builtin_amdgcn_mfma_f32_32x32x16_bf16(k0, qr[d0], p0, 0, 0, 0);
            p1 = __builtin_amdgcn_mfma_f32_32x32x16_bf16(k1, qr[d0], p1, 0, 0, 0); }
        if (diag) { const int kbase = j * 128 + kh * 64 + 4 * hi; const float NEG = -__builtin_inff();
#pragma unroll
            for (int r = 0; r < 16; ++r) { const int key = kbase + (r & 3) + 8 * (r >> 2); if (key > qpos) p0[r] = NEG; if (key + 32 > qpos) p1[r] = NEG; } }
        float pmax = p0[0];
#pragma unroll
        for (int r = 1; r < 16; ++r) pmax = fmaxf(pmax, p0[r]);
#pragma unroll
        for (int r = 0; r < 16; ++r) pmax = fmaxf(pmax, p1[r]);
        { auto rr = __builtin_amdgcn_permlane32_swap(__float_as_uint(pmax), __float_as_uint(pmax), false, false); pmax = fmaxf(__uint_as_float(rr[0]), __uint_as_float(rr[1])); }
        if (!__all(pmax - m_reg <= THR)) {
            const float mn = fmaxf(m_reg, pmax); const float alpha = __builtin_amdgcn_exp2f(m_reg - mn); m_reg = mn; l_reg *= alpha;
            if (hi == 0) wsf[r32] = alpha;
            asm volatile("s_waitcnt lgkmcnt(0)" ::: "memory");
#pragma unroll
            for (int r = 0; r < 16; ++r) { const float al = wsf[crow(r, hi)];
#pragma unroll
                for (int d = 0; d < 4; ++d) o[d][r] *= al; }
        }
#pragma unroll
        for (int r = 0; r < 16; ++r) { p0[r] = __builtin_amdgcn_exp2f(p0[r] - m_reg); p1[r] = __builtin_amdgcn_exp2f(p1[r] - m_reg); }
        float ps = 0.f;
#pragma unroll
        for (int r = 0; r < 16; ++r) ps += p0[r] + p1[r];
        { auto rr = __builtin_amdgcn_permlane32_swap(__float_as_uint(ps), __float_as_uint(ps), false, false); ps = __uint_as_float(rr[0]) + __uint_as_float(rr[1]); }
        l_reg += ps;
        bf16x8 pa0, pa1, pa2, pa3;
#define ATT_PK4(P, B_, OUT) do { const unsigned a0 = cvtpk(P[B_ + 0], P[B_ + 1]), a1 = cvtpk(P[B_ + 2], P[B_ + 3]), b0 = cvtpk(P[B_ + 4], P[B_ + 5]), b1 = cvtpk(P[B_ + 6], P[B_ + 7]); \
        auto r0 = __builtin_amdgcn_permlane32_swap(a0, b0, false, false); auto r1 = __builtin_amdgcn_permlane32_swap(a1, b1, false, false); \
        u32x4 w = {r0[0], r1[0], r0[1], r1[1]}; OUT = *reinterpret_cast<bf16x8*>(&w); } while (0)
        ATT_PK4(p0, 0, pa0); ATT_PK4(p0, 8, pa1); ATT_PK4(p1, 0, pa2); ATT_PK4(p1, 8, pa3);
#undef ATT_PK4
        ATT_SBAR();
        if (j + 1 < nst) ATT_LOAD(j + 1);
#define ATT_TRRD(dst, off) asm volatile("ds_read_b64_tr_b16 %0, %1 offset:%2" : "=&v"(dst) : "v"(vb0), "i"(off) : "memory")
#define ATT_PV(d0) do { s16x4 l0, l1, l2, l3, h0, h1, h2, h3; constexpr int b_ = (d0) * 512; \
        ATT_TRRD(l0, b_); ATT_TRRD(h0, b_ + 2048); ATT_TRRD(l1, b_ + 4096); ATT_TRRD(h1, b_ + 6144); ATT_TRRD(l2, b_ + 8192); ATT_TRRD(h2, b_ + 10240); ATT_TRRD(l3, b_ + 12288); ATT_TRRD(h3, b_ + 14336); \
        asm volatile("s_waitcnt lgkmcnt(0)" ::: "memory"); ATT_SBAR(); \
        o[d0] = __builtin_amdgcn_mfma_f32_32x32x16_bf16(pa0, (bf16x8){l0[0], l0[1], l0[2], l0[3], h0[0], h0[1], h0[2], h0[3]}, o[d0], 0, 0, 0); \
        o[d0] = __builtin_amdgcn_mfma_f32_32x32x16_bf16(pa1, (bf16x8){l1[0], l1[1], l1[2], l1[3], h1[0], h1[1], h1[2], h1[3]}, o[d0], 0, 0, 0); \
        o[d0] = __builtin_amdgcn_mfma_f32_32x32x16_bf16(pa2, (bf16x8){l2[0], l2[1], l2[2], l2[3], h2[0], h2[1], h2[2], h2[3]}, o[d0], 0, 0, 0); \
        o[d0] = __builtin_amdgcn_mfma_f32_32x32x16_bf16(pa3, (bf16x8){l3[0], l3[1], l3[2], l3[3], h3[0], h3[1], h3[2], h3[3]}, o[d0], 0, 0, 0); } while (0)
        ATT_SBAR(); ATT_PV(0); ATT_PV(1); ATT_PV(2); ATT_PV(3);
#undef ATT_PV
#undef ATT_TRRD
    }
    __syncthreads();
    ATT_LAS float* xo = (ATT_LAS float*)lds + rg * 4096;
    ATT_LAS float* xs = (ATT_LAS float*)(lds + LDS_XS) + rg * 64;
    if (kh == 1) {
#pragma unroll
        for (int d = 0; d < 4; ++d)
#pragma unroll
            for (int r = 0; r < 16; ++r) xo[(d * 16 + r) * 64 + lane] = o[d][r];
        if (hi == 0) { xs[r32] = m_reg; xs[32 + r32] = l_reg; }
    }
    __syncthreads();
    if (kh == 0) {
        const float m2 = xs[r32], l2 = xs[32 + r32];
        const float mm = fmaxf(m_reg, m2); const float f1 = __builtin_amdgcn_exp2f(m_reg - mm), f2 = __builtin_amdgcn_exp2f(m2 - mm);
        const float inv = __builtin_amdgcn_rcpf(l_reg * f1 + l2 * f2);
        if (hi == 0) { wsf[r32] = f1 * inv; wsf[32 + r32] = f2 * inv; }
        asm volatile("s_waitcnt lgkmcnt(0)" ::: "memory");
        bf16_t* Ow = MIX + ((size_t)b * S + (size_t)qb * 128 + rg * 32) * 2048 + 1024 + h * 128;
        float* sq = ssq_a + (size_t)b * S + qb * 128 + rg * 32;
        int loff = hi * 4 * 2048 + r32, hoff = hi * 4; asm volatile("" : "+v"(loff), "+v"(hoff));
#pragma unroll
        for (int r = 0; r < 16; ++r) { const int cr = (r & 3) + 8 * (r >> 2); const float g1 = wsf[cr + hoff], g2 = wsf[32 + cr + hoff]; float ss = 0.f;
#pragma unroll
            for (int d = 0; d < 4; ++d) { const float v = o[d][r] * g1 + xo[(d * 16 + r) * 64 + lane] * g2; ss += v * v;
                const float vn = __shfl_xor(v, 1);
                if ((r32 & 1) == 0) *(unsigned*)(Ow + (unsigned)(loff + cr * 2048 + d * 32)) = cvtpk(v, vn); }
            ss += __shfl_xor(ss, 1); ss += __shfl_xor(ss, 2); ss += __shfl_xor(ss, 4); ss += __shfl_xor(ss, 8); ss += __shfl_xor(ss, 16);
            if (r32 == 0) atomicAdd(sq + (unsigned)(cr + hoff), ss); }
    }
    __syncthreads();
#undef ATT_LOAD
#undef ATT_WRITE
}
#undef ATT_SBAR
}

constexpr int NWAVES = 8;
#ifndef MK_N_LAUNCHES
#define MK_N_LAUNCHES 1
#endif
constexpr int N_PHASES = 10;
constexpr int N_LAUNCHES = MK_N_LAUNCHES;

constexpr int BATCH = 4, SEQ = 2048, DM = 2048, M = BATCH * SEQ;
constexpr int CONV_CH = 1024, CONV_K = 31, NH = 8, Q_LORA = 768, KV_LORA = 512, IN_COLS = 3392, IN_PAD = 3584, D_FF = 5632;
constexpr float EPS = 1e-6f;

constexpr size_t MiB = 1u << 20;
constexpr size_t WS_CTL = 0, CTL_ZERO_BYTES = 1 * MiB;
constexpr size_t WS_CS = 2 * MiB;
constexpr size_t WS_WIN = 5 * MiB;
constexpr size_t WS_WUQ = WS_WIN + 14 * MiB;
constexpr size_t WS_WUKV = WS_WUQ + 2 * MiB + 256 * 1024;
constexpr size_t WS_WOUT = WS_WUKV + 2 * MiB;
constexpr size_t WS_WGU = WS_WOUT + 8 * MiB;
constexpr size_t WS_WDN = WS_WGU + 44 * MiB;
constexpr size_t WS_H = 98 * MiB;
constexpr size_t WS_MIX = 98 * MiB;
constexpr size_t WS_U0 = 130 * MiB;
constexpr size_t WS_QL = 146 * MiB;
constexpr size_t WS_KVL = 158 * MiB;
constexpr size_t WS_QF = 166 * MiB;
constexpr size_t WS_KF = 190 * MiB;
constexpr size_t WS_V = 214 * MiB;
constexpr size_t WS_MIXO = 130 * MiB;
constexpr size_t WS_HF = 194 * MiB;
constexpr size_t WS_ACT = 98 * MiB;
constexpr size_t WS_FF = 186 * MiB;
constexpr size_t WS_END = 256 * MiB;
static_assert(WS_WDN + 22 * MiB <= WS_H && WS_V + 16 * MiB <= WS_END && WS_FF + 64 * MiB <= WS_END && WS_HF + 32 * MiB <= WS_END, "d_ws map");
constexpr int CW_TMO = 0;
constexpr int CW_BAR = 4096;
constexpr int CW_SSQ = 16384;
static_assert((CW_SSQ + 5 * 8192) * 4 <= (int)CTL_ZERO_BYTES, "CTL words inside the memset region");

constexpr int RING_OFF = 0, RING_BYTES = 131072;
constexpr int LDSCTL_OFF = RING_BYTES, MISC_OFF = LDSCTL_OFF + 320;
constexpr int LDS_BYTES = 147456;
static_assert(att::LDS_END <= RING_BYTES, "attention scratch inside the ring");

#define GAS __attribute__((address_space(1)))
#define LAS __attribute__((address_space(3)))
typedef unsigned short bf16;
typedef unsigned v4u __attribute__((ext_vector_type(4)));
typedef unsigned v2u __attribute__((ext_vector_type(2)));
typedef float f32x4 __attribute__((ext_vector_type(4)));
typedef float f32x2 __attribute__((ext_vector_type(2)));
typedef GAS unsigned gu32;
#define RLX_AGENT __ATOMIC_RELAXED, __HIP_MEMORY_SCOPE_AGENT
#define LDS_WAIT() asm volatile("s_waitcnt lgkmcnt(0)" ::: "memory")
#define VM_WAIT() asm volatile("s_waitcnt vmcnt(0)" ::: "memory")
__device__ __forceinline__ unsigned f2bf(float f) { unsigned u = __builtin_bit_cast(unsigned, f); return (u + 0x7fffu + ((u >> 16) & 1u)) >> 16; }
__device__ __forceinline__ unsigned pk2(float lo, float hi) { return f2bf(lo) | (f2bf(hi) << 16); }
__device__ __forceinline__ float bflo(unsigned w) { return __builtin_bit_cast(float, w << 16); }
__device__ __forceinline__ float bfhi(unsigned w) { return __builtin_bit_cast(float, w & 0xffff0000u); }

#define XB_TMO      128
#define XB_XCNT(j)  (256  + 64 * (j))
#define XB_XSUB(j)  (1280 + 64 * (j))
#define XB_XGEN(j)  (2304 + 64 * (j))
#define XB_TOP      3328
#define XB_TOPGEN   3392
#define XCD_BAR_WORDS 3456
#define XB_SPIN_CAP (1u << 18)

__device__ __forceinline__ unsigned xb_ld(unsigned* p)              { return __hip_atomic_load(p, __ATOMIC_RELAXED, __HIP_MEMORY_SCOPE_AGENT); }
__device__ __forceinline__ unsigned xb_add(unsigned* p, unsigned v) { return __hip_atomic_fetch_add(p, v, __ATOMIC_RELAXED, __HIP_MEMORY_SCOPE_AGENT); }
__device__ __forceinline__ unsigned xb_xcc_id() { return (unsigned)__builtin_amdgcn_s_getreg((3 << 11) | 20) & 0xFu; }
#define XB_SPIN(cond, bar) do { unsigned _sp = 0; while (cond) { __builtin_amdgcn_s_sleep(1); \
    if ((++_sp & 255u) == 0u) { if (xb_ld(&(bar)[XB_TMO])) break; if (_sp > XB_SPIN_CAP) { atomicAdd(&(bar)[XB_TMO], 1u); break; } } } } while (0)

struct XcdBarrier {
    unsigned* bar; unsigned x;
    volatile LAS unsigned* st;
};

__device__ __forceinline__ XcdBarrier xcd_barrier_post(unsigned* bar, volatile LAS unsigned* st) {
    XcdBarrier b; b.bar = bar; b.x = xb_xcc_id(); b.st = st;
    if (threadIdx.x == 0) (void)xb_add(&bar[XB_XCNT(b.x)], 1u);
    return b;
}
__device__ __forceinline__ void xcd_barrier_complete(unsigned* bar, unsigned x, unsigned& nloc, unsigned& nx) {
    const unsigned G = gridDim.x * gridDim.y * gridDim.z;
    unsigned sum, cnt, mine, sp = 0u;
    for (;;) {
        sum = 0u; cnt = 0u; mine = 0u;
#pragma unroll
        for (unsigned j = 0; j < 16; ++j) { const unsigned c = xb_ld(&bar[XB_XCNT(j)]); sum += c; cnt += (c > 0u) ? 1u : 0u; mine = (j == x) ? c : mine; }
        if (sum == G) break;
        __builtin_amdgcn_s_sleep(1);
        if ((++sp & 255u) == 0u) { if (xb_ld(&bar[XB_TMO])) break; if (sp > XB_SPIN_CAP) { atomicAdd(&bar[XB_TMO], 1u); break; } }
    }
    nloc = mine > 0u ? mine : 1u; nx = cnt > 0u ? cnt : 1u;
}

__device__ __forceinline__ void xcd_barrier(const XcdBarrier& b) {
    asm volatile("s_waitcnt vmcnt(0)" ::: "memory");
    __syncthreads();
    if (threadIdx.x == 0) {
        unsigned* bar = b.bar;
        __builtin_amdgcn_s_waitcnt(0);
        unsigned nloc = b.st[0], nx = b.st[1];
        if (nloc == 0u) { xcd_barrier_complete(bar, b.x, nloc, nx); b.st[0] = nloc; b.st[1] = nx; }
        const unsigned old = xb_add(&bar[XB_XSUB(b.x)], 1u);
        const unsigned gen = old / nloc;
        if (old + 1u == (gen + 1u) * nloc) {
            __builtin_amdgcn_fence(__ATOMIC_RELEASE, "agent");
            asm volatile("s_waitcnt vmcnt(0)" ::: "memory");
            const unsigned og = xb_add(&bar[XB_TOP], 1u);
            const unsigned tg = og / nx;
            if (og + 1u == (tg + 1u) * nx) xb_add(&bar[XB_TOPGEN], 1u);
            else XB_SPIN(xb_ld(&bar[XB_TOPGEN]) == tg, bar);
            __builtin_amdgcn_fence(__ATOMIC_ACQUIRE, "agent");
            xb_add(&bar[XB_XGEN(b.x)], 1u);
            asm volatile("s_waitcnt vmcnt(0)" ::: "memory");
        } else {
            XB_SPIN(xb_ld(&bar[XB_XGEN(b.x)]) == gen, bar);
            __builtin_amdgcn_fence(__ATOMIC_ACQUIRE, "agent");
            asm volatile("s_waitcnt vmcnt(0)" ::: "memory");
        }
    }
    __syncthreads();
}

struct Frame {
    LAS unsigned char* lds;
    volatile LAS unsigned* MISC;
    gu32* ctl;
    int tid, lane, wave;
    int vcu, G;
};
__device__ __forceinline__ float wave_sum(float v) {
#pragma unroll
    for (int o = 1; o < 64; o <<= 1) v += __shfl_xor(v, o);
    return v;
}
__device__ __forceinline__ void p0_transpose_item(const float* W, int N, int K, bf16* WT, int k0, int n0, int drow0, const float* sc, LAS float* scr, int lane) {
#pragma unroll 8
    for (int i = 0; i < 32; ++i) { const int kk = 2 * i + (lane >> 5); float v = W[(size_t)(k0 + kk) * N + n0 + (lane & 31)]; if (sc) v *= sc[k0 + kk]; scr[kk * 33 + (lane & 31)] = v; }
    LDS_WAIT(); asm volatile("" ::: "memory");
    const int c = lane & 7;
#pragma unroll
    for (int j = 0; j < 4; ++j) { const int n = (lane >> 3) + 8 * j; const LAS float* s = scr + (8 * c) * 33 + n;
        v4u o; o.x = pk2(s[0 * 33], s[1 * 33]); o.y = pk2(s[2 * 33], s[3 * 33]); o.z = pk2(s[4 * 33], s[5 * 33]); o.w = pk2(s[6 * 33], s[7 * 33]);
        *(GAS v4u*)(WT + (size_t)(drow0 + n) * K + k0 + 8 * c) = o; }
    LDS_WAIT(); asm volatile("" ::: "memory");
}
struct Ptrs {
    const float* x; const int* pos; const float* pre_mix; const float* w_in; const float* q_norm; const float* w_uq; const float* kv_norm; const float* w_ukv;
    const float* conv_w; const float* conv_b; const float* ln_g; const float* ln_b; const float* conv_on; const float* attn_on; const float* w_out;
    const float* post_mix; const float* pre_ffn; const float* w_gate; const float* w_up; const float* w_down; const float* post_ffn;
    float* out; unsigned char* ws;
};
__device__ __forceinline__ void p0_prologue(Frame& F, const Ptrs& P) {
    LAS float* scr = (LAS float*)(F.lds + RING_OFF + F.wave * 16384);
    const int gw = F.vcu * NWAVES + F.wave, NGW = F.G * NWAVES;
    bf16* Win_t = (bf16*)(P.ws + WS_WIN); bf16* Wuq_t = (bf16*)(P.ws + WS_WUQ); bf16* Wukv_t = (bf16*)(P.ws + WS_WUKV); bf16* Wout_t = (bf16*)(P.ws + WS_WOUT);
    bf16* Wgu_t = (bf16*)(P.ws + WS_WGU); bf16* Wdn_t = (bf16*)(P.ws + WS_WDN);
    constexpr int I_IN = (DM / 64) * (IN_COLS / 32), I_UQ = (Q_LORA / 64) * (1536 / 32), I_UKV = (KV_LORA / 64) * (2048 / 32), I_OUT = (2048 / 64) * (DM / 32);
    constexpr int I_G = (DM / 64) * (D_FF / 32), I_DN = (D_FF / 64) * (DM / 32), I_ZR = 192;
    constexpr int NITEMS = I_IN + I_UQ + I_UKV + I_OUT + 2 * I_G + I_DN + I_ZR;
    for (int it = gw; it < NITEMS; it += NGW) {
        int r = it;
        if (r < I_IN) { const int nblk = IN_COLS / 32, kb = r / nblk, n0 = (r % nblk) * 32; int dr;
            if (n0 < 1024) dr = 256 * (n0 >> 7) + (n0 & 127); else if (n0 < 2048) { const int c = n0 - 1024; dr = 256 * (c >> 7) + 128 + (c & 127); } else if (n0 < 3328) dr = n0; else dr = (n0 == 3328) ? 3328 : 3456;
            p0_transpose_item(P.w_in, IN_COLS, DM, Win_t, kb * 64, n0, dr, nullptr, scr, F.lane); continue; } r -= I_IN;
        if (r < I_UQ) { const int nblk = 1536 / 32, kb = r / nblk, n0 = (r % nblk) * 32; const int h = n0 / 192, d0 = n0 % 192; int dr;
            if (d0 < 128) dr = h * 128 + d0; else dr = 1024 + 256 * (h >> 2) + (h & 3) * 32 + (d0 >= 160 ? 128 : 0);
            p0_transpose_item(P.w_uq, 1536, Q_LORA, Wuq_t, kb * 64, n0, dr, P.q_norm, scr, F.lane); continue; } r -= I_UQ;
        if (r < I_UKV) { const int nblk = 2048 / 32, kb = r / nblk, n0 = (r % nblk) * 32;
            p0_transpose_item(P.w_ukv, 2048, KV_LORA, Wukv_t, kb * 64, n0, n0, P.kv_norm, scr, F.lane); continue; } r -= I_UKV;
        if (r < I_OUT) { const int nblk = DM / 32, kb = r / nblk, n0 = (r % nblk) * 32;
            p0_transpose_item(P.w_out, DM, 2048, Wout_t, kb * 64, n0, n0, (kb * 64 >= 1024) ? P.attn_on - 1024 : nullptr, scr, F.lane); continue; } r -= I_OUT;
        if (r < 2 * I_G) { const bool up = r >= I_G; if (up) r -= I_G; const int nblk = D_FF / 32, kb = r / nblk, n0 = (r % nblk) * 32;
            p0_transpose_item(up ? P.w_up : P.w_gate, D_FF, DM, Wgu_t, kb * 64, n0, 256 * (n0 >> 7) + (up ? 128 : 0) + (n0 & 127), nullptr, scr, F.lane); continue; } r -= 2 * I_G;
        if (r < I_DN) { const int nblk = DM / 32, kb = r / nblk, n0 = (r % nblk) * 32;
            p0_transpose_item(P.w_down, DM, D_FF, Wdn_t, kb * 64, n0, n0, nullptr, scr, F.lane); continue; } r -= I_DN;
        { const int row = (r < 96) ? 3328 + 32 + r : 3456 + 32 + (r - 96);
          GAS v4u* o = (GAS v4u*)(Win_t + (size_t)row * DM) + F.lane;
#pragma unroll
          for (int j = 0; j < 4; ++j) o[64 * j] = (v4u){0u, 0u, 0u, 0u}; }
    }
    bf16* Hb = (bf16*)(P.ws + WS_H); float* cs = (float*)(P.ws + WS_CS);
    for (int m = gw; m < M; m += NGW) {
        const GAS f32x4* xr = (const GAS f32x4*)(P.x + (size_t)m * DM) + F.lane; const GAS f32x4* gr = (const GAS f32x4*)P.pre_mix + F.lane;
        f32x4 v[8]; float s = 0.f;
#pragma unroll
        for (int j = 0; j < 8; ++j) { v[j] = xr[64 * j]; s += (v[j].x * v[j].x + v[j].y * v[j].y) + (v[j].z * v[j].z + v[j].w * v[j].w); }
        const float rs = rsqrtf(wave_sum(s) * (1.f / DM) + EPS);
        GAS v2u* o8 = (GAS v2u*)(Hb + (size_t)m * DM) + F.lane;
#pragma unroll
        for (int j = 0; j < 8; ++j) { const f32x4 g = gr[64 * j]; o8[64 * j] = (v2u){pk2(v[j].x * rs * g.x, v[j].y * rs * g.y), pk2(v[j].z * rs * g.z, v[j].w * rs * g.w)}; }
        if (F.lane < 32) { const float p = (float)P.pos[m]; const float inv = powf(10000.0f, -(float)(2 * F.lane) / 64.0f); const float ang = p * inv;
            cs[(size_t)m * 64 + F.lane] = cosf(ang); cs[(size_t)m * 64 + 32 + F.lane] = sinf(ang); }
    }
}
__device__ __forceinline__ float block_stat_reduce(LAS float* red, LAS float* fin, int nstat, int tid) { return 0.f; }
__device__ __forceinline__ void conv_item(Frame& F, const Ptrs& P, int item) {
    const int tid = F.tid, row0 = item * 16, t0 = row0 & (SEQ - 1), c0 = 2 * tid;
    const GAS unsigned* U0 = (const GAS unsigned*)(P.ws + WS_U0);
    LAS float* red = (LAS float*)(F.lds + RING_OFF);
    LAS float* fin = (LAS float*)(F.lds + RING_OFF + 65536);
    float uw[46][2];
#pragma unroll
    for (int j = 0; j < 46; ++j) { const bool ok = (t0 - 30 + j) >= 0; const int rr = ok ? (row0 - 30 + j) : row0; const unsigned w = U0[((size_t)rr * CONV_CH + c0) >> 1];
        uw[j][0] = ok ? bflo(w) : 0.f; uw[j][1] = ok ? bfhi(w) : 0.f; }
    float acc[16][2];
    { const f32x2 bb = *(const GAS f32x2*)(P.conv_b + c0);
#pragma unroll
      for (int t = 0; t < 16; ++t) { acc[t][0] = bb.x; acc[t][1] = bb.y; } }
#pragma unroll
    for (int k = 0; k < CONV_K; ++k) { const f32x2 w = *(const GAS f32x2*)(P.conv_w + (size_t)k * CONV_CH + c0);
#pragma unroll
        for (int t = 0; t < 16; ++t) { acc[t][0] += w.x * uw[t + k][0]; acc[t][1] += w.y * uw[t + k][1]; } }
#pragma unroll
    for (int t = 0; t < 16; ++t) { red[(2 * t) * 512 + tid] = acc[t][0] + acc[t][1]; red[(2 * t + 1) * 512 + tid] = acc[t][0] * acc[t][0] + acc[t][1] * acc[t][1]; }
    __syncthreads();
    { const int v = tid >> 4, part = tid & 15; float s = 0.f;
#pragma unroll 8
      for (int i = 0; i < 32; ++i) s += red[v * 512 + part + 16 * i];
      s += __shfl_xor(s, 1); s += __shfl_xor(s, 2); s += __shfl_xor(s, 4); s += __shfl_xor(s, 8);
      if (part == 0) fin[v] = s; }
    __syncthreads();
    const f32x2 lg = *(const GAS f32x2*)(P.ln_g + c0), lb = *(const GAS f32x2*)(P.ln_b + c0);
    float ss[16];
#pragma unroll
    for (int t = 0; t < 16; ++t) { const float mu = fin[2 * t] * (1.f / CONV_CH); const float var = fin[2 * t + 1] * (1.f / CONV_CH) - mu * mu; const float rstd = rsqrtf(fmaxf(var, 0.f) + EPS);
        float y0 = (acc[t][0] - mu) * rstd * lg.x + lb.x, y1 = (acc[t][1] - mu) * rstd * lg.y + lb.y;
        y0 = y0 * pg8::sigm(y0); y1 = y1 * pg8::sigm(y1); acc[t][0] = y0; acc[t][1] = y1; ss[t] = y0 * y0 + y1 * y1; }
    __syncthreads();
#pragma unroll
    for (int t = 0; t < 16; ++t) red[t * 512 + tid] = ss[t];
    __syncthreads();
    { const int v = tid >> 5, part = tid & 31; float s = 0.f;
#pragma unroll 8
      for (int i = 0; i < 16; ++i) s += red[v * 512 + part + 32 * i];
      s += __shfl_xor(s, 1); s += __shfl_xor(s, 2); s += __shfl_xor(s, 4); s += __shfl_xor(s, 8); s += __shfl_xor(s, 16);
      if (part == 0) fin[v] = s; }
    __syncthreads();
    const f32x2 og = *(const GAS f32x2*)(P.conv_on + c0);
    GAS unsigned* MIXu = (GAS unsigned*)(P.ws + WS_MIX);
#pragma unroll
    for (int t = 0; t < 16; ++t) { const float rs = rsqrtf(fin[t] * (1.f / CONV_CH) + EPS);
        MIXu[((size_t)(row0 + t) * 2048 + c0) >> 1] = pk2(acc[t][0] * rs * og.x, acc[t][1] * rs * og.y); }
    __syncthreads();
}
__device__ __forceinline__ void p4_attn_norm(Frame& F, const Ptrs& P) {
    const int gw = F.vcu * NWAVES + F.wave, NGW = F.G * NWAVES; const float* ssq = (const float*)(P.ws + WS_CTL) + CW_SSQ + 2 * 8192;
    for (int m = gw; m < M; m += NGW) { const float rs = rsqrtf(ssq[m] * (1.f / 1024.f) + EPS);
        GAS v4u* p = (GAS v4u*)((bf16*)(P.ws + WS_MIX) + (size_t)m * 2048 + 1024) + F.lane;
#pragma unroll
        for (int j = 0; j < 2; ++j) { v4u w = p[64 * j]; v4u o;
            o.x = pk2(bflo(w.x) * rs, bfhi(w.x) * rs); o.y = pk2(bflo(w.y) * rs, bfhi(w.y) * rs); o.z = pk2(bflo(w.z) * rs, bfhi(w.z) * rs); o.w = pk2(bflo(w.w) * rs, bfhi(w.w) * rs); p[64 * j] = o; } }
}
__device__ __forceinline__ void p6_residual_norms(Frame& F, const Ptrs& P) {
    const int gw = F.vcu * NWAVES + F.wave, NGW = F.G * NWAVES; const float* ssq = (const float*)(P.ws + WS_CTL) + CW_SSQ + 3 * 8192;
    for (int m = gw; m < M; m += NGW) { const float rs1 = rsqrtf(ssq[m] * (1.f / DM) + EPS);
        const GAS f32x4* xr = (const GAS f32x4*)(P.x + (size_t)m * DM) + F.lane; const GAS f32x4* mr = (const GAS f32x4*)((const float*)(P.ws + WS_MIXO) + (size_t)m * DM) + F.lane;
        const GAS f32x4* g1 = (const GAS f32x4*)P.post_mix + F.lane; const GAS f32x4* g2 = (const GAS f32x4*)P.pre_ffn + F.lane;
        GAS f32x4* orow = (GAS f32x4*)(P.out + (size_t)m * DM) + F.lane;
        f32x4 v[8]; float s = 0.f;
#pragma unroll
        for (int j = 0; j < 8; ++j) { v[j] = xr[64 * j] + mr[64 * j] * rs1 * g1[64 * j]; orow[64 * j] = v[j]; s += (v[j].x * v[j].x + v[j].y * v[j].y) + (v[j].z * v[j].z + v[j].w * v[j].w); }
        const float rs2 = rsqrtf(wave_sum(s) * (1.f / DM) + EPS);
        GAS v2u* o8 = (GAS v2u*)((bf16*)(P.ws + WS_HF) + (size_t)m * DM) + F.lane;
#pragma unroll
        for (int j = 0; j < 8; ++j) { const f32x4 g = g2[64 * j]; o8[64 * j] = (v2u){pk2(v[j].x * rs2 * g.x, v[j].y * rs2 * g.y), pk2(v[j].z * rs2 * g.z, v[j].w * rs2 * g.w)}; } }
}
__device__ __forceinline__ void p9_final(Frame& F, const Ptrs& P) {
    const int gw = F.vcu * NWAVES + F.wave, NGW = F.G * NWAVES; const float* ssq = (const float*)(P.ws + WS_CTL) + CW_SSQ + 4 * 8192;
    for (int m = gw; m < M; m += NGW) { const float rs = rsqrtf(ssq[m] * (1.f / DM) + EPS);
        const GAS f32x4* fr = (const GAS f32x4*)((const float*)(P.ws + WS_FF) + (size_t)m * DM) + F.lane; const GAS f32x4* g = (const GAS f32x4*)P.post_ffn + F.lane;
        GAS f32x4* orow = (GAS f32x4*)(P.out + (size_t)m * DM) + F.lane;
#pragma unroll
        for (int j = 0; j < 8; ++j) orow[64 * j] = orow[64 * j] + fr[64 * j] * rs * g[64 * j]; }
}

struct Args { Ptrs p; int ph_lo, ph_hi; };
__global__ void __launch_bounds__(NWAVES * 64, 2) hymba_fwd(Args args) {
    extern __shared__ __attribute__((aligned(16))) unsigned char lds[];
    Frame F;
    F.lds = (LAS unsigned char*)lds;
    F.MISC = (volatile LAS unsigned*)(F.lds + MISC_OFF);
    F.tid = threadIdx.x; F.lane = F.tid & 63; F.wave = __builtin_amdgcn_readfirstlane(F.tid >> 6);
    F.G = gridDim.x; { const int bx = blockIdx.x; F.vcu = (F.G % 8 == 0) ? (bx % 8) * (F.G / 8) + bx / 8 : bx; }
    const Ptrs& P = args.p;
    unsigned char* ws = P.ws;
    F.ctl = (gu32*)(ws + WS_CTL);
    for (int u = F.tid; u < (LDS_BYTES - LDSCTL_OFF) / 4; u += NWAVES * 64) ((LAS unsigned*)(F.lds + LDSCTL_OFF))[u] = 0u;
    __syncthreads();
    XcdBarrier bar; bar.bar = (unsigned*)(F.ctl + CW_BAR); bar.x = 0; bar.st = nullptr;
    if (N_LAUNCHES == 1) bar = xcd_barrier_post((unsigned*)(F.ctl + CW_BAR), F.MISC + 8);
#define GRID_BAR() do { if (N_LAUNCHES == 1) xcd_barrier(bar); } while (0)
    const int lo = args.ph_lo, hi = args.ph_hi;
#ifndef PH_MASK
#define PH_MASK 0x3ff
#endif
#define IN(k) (((PH_MASK >> (k)) & 1) && lo <= (k) && (k) < hi)
#define BOTH(k) (IN(k) && IN((k) + 1))
    float* ssqf = (float*)(ws + WS_CTL) + CW_SSQ;
    bf16* Hb = (bf16*)(ws + WS_H); bf16* MIX = (bf16*)(ws + WS_MIX); bf16* U0 = (bf16*)(ws + WS_U0); bf16* QL = (bf16*)(ws + WS_QL); bf16* KVL = (bf16*)(ws + WS_KVL);
    bf16* QF = (bf16*)(ws + WS_QF); bf16* KF = (bf16*)(ws + WS_KF); bf16* Vb = (bf16*)(ws + WS_V); bf16* HF = (bf16*)(ws + WS_HF); bf16* ACT = (bf16*)(ws + WS_ACT);
    const float* cs = (const float*)(ws + WS_CS);

    if (IN(0)) { p0_prologue(F, P); if (BOTH(0)) GRID_BAR(); }
    if (IN(1)) {
        pg8::Gemm g{Hb, (const bf16*)(ws + WS_WIN), M, IN_PAD, DM}; pg8::StaticOrder S; S.init(M, IN_PAD, F.G, (int)blockIdx.x);
        pg8::EpiZ E{U0, QL, KVL, KF, ssqf, ssqf + 8192, cs};
        pg8::gemm_phase<pg8::EpiZ, pg8::StaticOrder, true, true>(F.lds + RING_OFF, g, S, E);
        if (BOTH(1)) GRID_BAR();
    }
    if (IN(2)) {
        for (int it = F.vcu; it < M / 16; it += F.G) conv_item(F, P, it);
        { pg8::Gemm g{QL, (const bf16*)(ws + WS_WUQ), M, 1536, Q_LORA}; pg8::StaticOrder S; S.init(M, 1536, F.G, (int)blockIdx.x);
          pg8::EpiQ E{QF, ssqf, cs};
          pg8::gemm_phase<pg8::EpiQ, pg8::StaticOrder, true, true>(F.lds + RING_OFF, g, S, E); }
        { pg8::Gemm g{KVL, (const bf16*)(ws + WS_WUKV), M, 2048, KV_LORA}; pg8::StaticOrder S; S.init(M, 2048, F.G, (int)blockIdx.x);
          pg8::EpiKV E{KF, Vb, ssqf + 8192};
          pg8::gemm_phase<pg8::EpiKV, pg8::StaticOrder, true, true>(F.lds + RING_OFF, g, S, E); }
        if (BOTH(2)) GRID_BAR();
    }
    if (IN(3)) {
        for (int it = F.vcu; it < 256; it += F.G) { const int bh = it >> 3, s = it & 7;
            for (int pass = 0; pass < 2; ++pass) att::attn_unit(bh >> 3, bh & 7, pass ? 15 - s : s, QF, KF, Vb, MIX, ssqf + 2 * 8192, F.lds + RING_OFF); }
        if (BOTH(3)) GRID_BAR();
    }
    if (IN(4)) { p4_attn_norm(F, P); if (BOTH(4)) GRID_BAR(); }
    if (IN(5)) {
        pg8::Gemm g{MIX, (const bf16*)(ws + WS_WOUT), M, DM, 2048}; pg8::StaticOrder S; S.init(M, DM, F.G, (int)blockIdx.x);
        pg8::EpiF32SS E{(float*)(ws + WS_MIXO), DM, ssqf + 3 * 8192};
        pg8::gemm_phase<pg8::EpiF32SS, pg8::StaticOrder, true, true>(F.lds + RING_OFF, g, S, E);
        if (BOTH(5)) GRID_BAR();
    }
    if (IN(6)) { p6_residual_norms(F, P); if (BOTH(6)) GRID_BAR(); }
    if (IN(7)) {
        pg8::Gemm g{HF, (const bf16*)(ws + WS_WGU), M, 2 * D_FF, DM}; pg8::StaticOrder S; S.init(M, 2 * D_FF, F.G, (int)blockIdx.x);
        pg8::EpiSwiGLU E{ACT};
        pg8::gemm_phase<pg8::EpiSwiGLU, pg8::StaticOrder, true, true>(F.lds + RING_OFF, g, S, E);
        if (BOTH(7)) GRID_BAR();
    }
    if (IN(8)) {
        pg8::Gemm g{ACT, (const bf16*)(ws + WS_WDN), M, DM, D_FF}; pg8::StaticOrder S; S.init(M, DM, F.G, (int)blockIdx.x);
        pg8::EpiF32SS E{(float*)(ws + WS_FF), DM, ssqf + 4 * 8192};
        pg8::gemm_phase<pg8::EpiF32SS, pg8::StaticOrder, true, true>(F.lds + RING_OFF, g, S, E);
        if (BOTH(8)) GRID_BAR();
    }
    if (IN(9)) { p9_final(F, P); }
#undef IN
#undef BOTH
#undef GRID_BAR
}

extern "C" void kernel_launch(void* const* d_in, const int* in_sizes, int n_in, void* d_out, int out_size, void* d_ws, size_t ws_size, hipStream_t stream) {
    static int grid = 0;
    if (grid == 0) {
        if (n_in != 21 || in_sizes[0] != M * DM || out_size != M * DM || ws_size < WS_END) { fprintf(stderr, "kernel_launch: unexpected shapes (n_in %d, in0 %d, out %d, ws %zu); nothing launched\n", n_in, n_in > 0 ? in_sizes[0] : -1, out_size, ws_size); grid = -1; return; }
        int dev = 0, cus = 0, per_cu = 0;
        if (hipGetDevice(&dev) != hipSuccess || hipDeviceGetAttribute(&cus, hipDeviceAttributeMultiprocessorCount, dev) != hipSuccess) { grid = -1; return; }
        if (hipFuncSetAttribute((const void*)hymba_fwd, hipFuncAttributeMaxDynamicSharedMemorySize, LDS_BYTES) != hipSuccess) { fprintf(stderr, "kernel_launch: hipFuncSetAttribute failed\n"); grid = -1; return; }
        if (hipOccupancyMaxActiveBlocksPerMultiprocessor(&per_cu, (const void*)hymba_fwd, NWAVES * 64, LDS_BYTES) != hipSuccess || per_cu < 1) { fprintf(stderr, "kernel_launch: occupancy query reports %d workgroups per CU\n", per_cu); }
        (void)hipGetLastError();
        grid = cus;
    }
    if (grid < 0) return;
    (void)hipMemsetAsync((char*)d_ws + WS_CTL, 0, CTL_ZERO_BYTES, stream);
    Args a{};
    a.p.x = (const float*)d_in[0]; a.p.pos = (const int*)d_in[1]; a.p.pre_mix = (const float*)d_in[2]; a.p.w_in = (const float*)d_in[3]; a.p.q_norm = (const float*)d_in[4];
    a.p.w_uq = (const float*)d_in[5]; a.p.kv_norm = (const float*)d_in[6]; a.p.w_ukv = (const float*)d_in[7]; a.p.conv_w = (const float*)d_in[8]; a.p.conv_b = (const float*)d_in[9];
    a.p.ln_g = (const float*)d_in[10]; a.p.ln_b = (const float*)d_in[11]; a.p.conv_on = (const float*)d_in[12]; a.p.attn_on = (const float*)d_in[13]; a.p.w_out = (const float*)d_in[14];
    a.p.post_mix = (const float*)d_in[15]; a.p.pre_ffn = (const float*)d_in[16]; a.p.w_gate = (const float*)d_in[17]; a.p.w_up = (const float*)d_in[18]; a.p.w_down = (const float*)d_in[19];
    a.p.post_ffn = (const float*)d_in[20]; a.p.out = (float*)d_out; a.p.ws = (unsigned char*)d_ws;
    if (N_LAUNCHES == 1) { a.ph_lo = 0; a.ph_hi = N_PHASES; hipLaunchKernelGGL(hymba_fwd, dim3(grid), dim3(NWAVES * 64), LDS_BYTES, stream, a); }
    else for (int li = 0; li < N_PHASES; ++li) { a.ph_lo = li; a.ph_hi = li + 1; hipLaunchKernelGGL(hymba_fwd, dim3(grid), dim3(NWAVES * 64), LDS_BYTES, stream, a); }
}
```
